# Optimizing an MI355X kernel written in HIP

```python
import math
import jax, jax.numpy as jnp
from jax import lax
import numpy as np

D_MODEL = 1024
BATCH = 4
SEQ = 4096
DEPTH = 1
DEC_BATCH = 16
DEC_SEQ = 32
PAST_LEN = 2048

CHUNK = 64
RET_HEADS = 4
RET_DK = 128
RET_DV = 128
SB_HEADS = 8
SB_DH = 64
SB_BLOCK = 128
MIX_WIDTH = RET_HEADS * RET_DV + SB_HEADS * SB_DH
N_MEM = 256
MEM_HEADS = 4
MEM_DH = D_MODEL // MEM_HEADS
D_FF = 2816
CONV_W = 3
ROPE_BASE = 10000.0
LN_EPS = 1e-5
RMS_EPS = 1e-6
DN_ALPHA = (2.0 * DEPTH) ** 0.25
DN_BETA = (8.0 * DEPTH) ** -0.25
IN_SIZES = (RET_HEADS * RET_DK, RET_HEADS * RET_DK, RET_HEADS * RET_DV, RET_HEADS * RET_DV,
            SB_HEADS * SB_DH, SB_HEADS * SB_DH, SB_HEADS * SB_DH)
IN_WIDTH = sum(IN_SIZES)
IN_SPLITS = tuple(int(s) for s in np.cumsum(IN_SIZES)[:-1])

kernel_name = "retention_stickbreaking_hybrid_stream_step"


def layer_norm(x, g, b):
    xf = x.astype(jnp.float32)
    mu = jnp.mean(xf, -1, keepdims=True)
    var = jnp.mean(jnp.square(xf - mu), -1, keepdims=True)
    y = (xf - mu) * lax.rsqrt(var + LN_EPS) * g.astype(jnp.float32) + b.astype(jnp.float32)
    return y.astype(x.dtype)


def split_heads(t, n):
    b, s, w = t.shape
    return t.reshape(b, s, n, w // n).transpose(0, 2, 1, 3)


def merge_heads(t):
    b, h, s, d = t.shape
    return t.transpose(0, 2, 1, 3).reshape(b, s, h * d)


def rope(x, pos):
    half = x.shape[-1] // 2
    inv = 1.0 / (ROPE_BASE ** (jnp.arange(half, dtype=jnp.float32) / half))
    ang = pos.astype(jnp.float32)[:, None] * inv[None, :]
    cos, sin = jnp.cos(ang).astype(x.dtype), jnp.sin(ang).astype(x.dtype)
    x1, x2 = x[..., :half], x[..., half:]
    return jnp.concatenate([x1 * cos - x2 * sin, x1 * sin + x2 * cos], axis=-1)


def retention(q, k, v, s0, chunk):
    b, h, t, dk = q.shape
    dv = v.shape[-1]
    n = t // chunk
    log_g = jnp.log1p(-(2.0 ** (-5.0 - jnp.arange(h, dtype=jnp.float32))))
    idx = jnp.arange(chunk, dtype=jnp.float32)
    diff = idx[:, None] - idx[None, :]
    decay_mask = jnp.where(diff >= 0, jnp.exp(log_g[:, None, None] * jnp.maximum(diff, 0.0)), 0.0)
    q_dec = jnp.exp(log_g[:, None] * (idx + 1.0))
    k_dec = jnp.exp(log_g[:, None] * (chunk - 1.0 - idx))
    chunk_dec = jnp.exp(log_g * chunk)
    qc = q.astype(jnp.float32).reshape(b, h, n, chunk, dk)
    kc = k.astype(jnp.float32).reshape(b, h, n, chunk, dk)
    vc = v.astype(jnp.float32).reshape(b, h, n, chunk, dv)
    scores = jnp.einsum('bhnid,bhnjd->bhnij', qc, kc) * decay_mask[None, :, None]
    o_intra = jnp.einsum('bhnij,bhnje->bhnie', scores, vc)
    u = jnp.einsum('bhnjd,bhnje->nbhde', kc * k_dec[None, :, None, :, None], vc)

    def step(s, u_n):
        return chunk_dec[None, :, None, None] * s + u_n, s

    s_final, s_prev = lax.scan(step, s0.astype(jnp.float32), u)
    o_cross = jnp.einsum('bhnid,nbhde->bhnie', qc * q_dec[None, :, None, :, None], s_prev)
    return (o_intra + o_cross).reshape(b, h, t, dv), s_final


def stick_breaking_block(q, k, v, q_pos, k_pos):
    z = jnp.einsum('bhqd,bhkd->bhqk', q, k).astype(jnp.float32) * (SB_DH ** -0.5)
    valid = k_pos[None, :] < q_pos[:, None]
    log_fail = jnp.where(valid, jax.nn.log_sigmoid(-z), 0.0)
    after = lax.cumsum(log_fail, axis=3, reverse=True) - log_fail
    a = jnp.where(valid, jnp.exp(jax.nn.log_sigmoid(z) + after), 0.0)
    return jnp.einsum('bhqk,bhkd->bhqd', a, v.astype(jnp.float32)).astype(v.dtype)


def stick_breaking_attention(q, k_all, v_all, q_pos):
    b, h, t, d = q.shape
    qb = min(SB_BLOCK, t)
    nb = t // qb
    k_pos = jnp.arange(k_all.shape[2], dtype=jnp.int32)
    q_blocks = q.reshape(b, h, nb, qb, d).transpose(2, 0, 1, 3, 4)
    pos_blocks = q_pos.reshape(nb, qb)
    out = lax.map(lambda a: stick_breaking_block(a[0], k_all, v_all, a[1], k_pos), (q_blocks, pos_blocks))
    return out.transpose(1, 2, 0, 3, 4).reshape(b, h, t, d)


def memory_attention(x, mem_k, mem_v, w_q, w_o):
    q = split_heads(x @ w_q, MEM_HEADS)
    s = jnp.einsum('bhtd,bhmd->bhtm', q, mem_k.astype(q.dtype)).astype(jnp.float32) * (MEM_DH ** -0.5)
    p = jax.nn.softmax(s, axis=-1).astype(x.dtype)
    o = jnp.einsum('bhtm,bhmd->bhtd', p, mem_v.astype(x.dtype))
    return merge_heads(o) @ w_o


def conv_ffn(x, conv_past, w_up, conv_w, conv_b, w_down):
    t = x.shape[1]
    u = x @ w_up
    u_pad = jnp.concatenate([conv_past.astype(u.dtype), u], axis=1)
    c = conv_b
    for j in range(CONV_W):
        c = c + conv_w[j] * u_pad[:, j:j + t]
    a, g = jnp.split(c, 2, axis=-1)
    return (jax.nn.silu(a) * g) @ w_down, u_pad[:, -(CONV_W - 1):]


def trunk_layer(x, mem_k, mem_v, ret_s0, sb_k_past, sb_v_past, conv_past, past_len,
                w_in, w_o, ln1_g, ln1_b, w_q_mem, w_o_mem, ln2_g, ln2_b,
                w_up, conv_w, conv_b, w_down, ln3_g, ln3_b):
    t = x.shape[1]
    pos = past_len + jnp.arange(t, dtype=jnp.int32)
    rq, rk, rv, rg, sq, sk, sv = jnp.split(x @ w_in, IN_SPLITS, axis=-1)
    rq = rope(split_heads(rq, RET_HEADS), pos)
    rk = rope(split_heads(rk, RET_HEADS), pos) * (RET_DK ** -0.5)
    rv = split_heads(rv, RET_HEADS)
    ro, ret_state = retention(rq, rk, rv, ret_s0, min(CHUNK, t))
    ro = ro * lax.rsqrt(jnp.mean(jnp.square(ro), -1, keepdims=True) + RMS_EPS)
    ro = merge_heads(ro.astype(x.dtype)) * jax.nn.silu(rg)
    sq, sk, sv = split_heads(sq, SB_HEADS), split_heads(sk, SB_HEADS), split_heads(sv, SB_HEADS)
    k_all = jnp.concatenate([sb_k_past.astype(sk.dtype), sk], axis=2)
    v_all = jnp.concatenate([sb_v_past.astype(sv.dtype), sv], axis=2)
    so = merge_heads(stick_breaking_attention(sq, k_all, v_all, pos))
    mix = jnp.concatenate([ro, so], axis=-1) @ w_o
    x = layer_norm(DN_ALPHA * x + mix, ln1_g, ln1_b)
    x = layer_norm(DN_ALPHA * x + memory_attention(x, mem_k, mem_v, w_q_mem, w_o_mem), ln2_g, ln2_b)
    f, conv_state = conv_ffn(x, conv_past, w_up, conv_w, conv_b, w_down)
    x = layer_norm(DN_ALPHA * x + f, ln3_g, ln3_b)
    return x, sk, sv, ret_state.astype(ret_s0.dtype), conv_state


def setup_inputs(seed: int = 0) -> dict:
    key = jax.random.key(seed)
    ks = jax.random.split(key, 26)
    f32 = jnp.float32

    def nrm(k, shape, scale):
        return jax.random.normal(k, shape, f32) * scale

    col_scale = jnp.asarray(np.concatenate([
        np.full((s,), DN_BETA if i in (2, 6) else 1.0, np.float32) for i, s in enumerate(IN_SIZES)]))
    return {
        "x_prompt": nrm(ks[0], (BATCH, SEQ, D_MODEL), 1.0),
        "x_sample": nrm(ks[1], (DEC_BATCH, DEC_SEQ, D_MODEL), 1.0),
        "cache_sb_k": nrm(ks[2], (DEPTH, DEC_BATCH, SB_HEADS, PAST_LEN, SB_DH), 1.0),
        "cache_sb_v": nrm(ks[3], (DEPTH, DEC_BATCH, SB_HEADS, PAST_LEN, SB_DH), DN_BETA),
        "state_ret": nrm(ks[4], (DEPTH, DEC_BATCH, RET_HEADS, RET_DK, RET_DV), 0.1),
        "state_ffn_conv": nrm(ks[5], (DEPTH, DEC_BATCH, CONV_W - 1, 2 * D_FF), 1.0),
        "cache_mem_k": nrm(ks[6], (DEPTH, DEC_BATCH, MEM_HEADS, N_MEM, MEM_DH), 1.0),
        "cache_mem_v": nrm(ks[7], (DEPTH, DEC_BATCH, MEM_HEADS, N_MEM, MEM_DH), DN_BETA),
        "mem_prompt": nrm(ks[8], (BATCH, N_MEM, D_MODEL), 1.0),
        "w_in": nrm(ks[9], (DEPTH, D_MODEL, IN_WIDTH), D_MODEL ** -0.5) * col_scale,
        "w_o": nrm(ks[10], (DEPTH, MIX_WIDTH, D_MODEL), MIX_WIDTH ** -0.5 * DN_BETA),
        "ln1_g": 1.0 + nrm(ks[11], (DEPTH, D_MODEL), 0.01),
        "ln1_b": nrm(ks[12], (DEPTH, D_MODEL), 0.01),
        "w_q_mem": nrm(ks[13], (DEPTH, D_MODEL, D_MODEL), D_MODEL ** -0.5),
        "w_k_mem": nrm(ks[14], (DEPTH, D_MODEL, D_MODEL), D_MODEL ** -0.5),
        "w_v_mem": nrm(ks[15], (DEPTH, D_MODEL, D_MODEL), D_MODEL ** -0.5 * DN_BETA),
        "w_o_mem": nrm(ks[16], (DEPTH, D_MODEL, D_MODEL), D_MODEL ** -0.5 * DN_BETA),
        "ln2_g": 1.0 + nrm(ks[17], (DEPTH, D_MODEL), 0.01),
        "ln2_b": nrm(ks[18], (DEPTH, D_MODEL), 0.01),
        "w_up": nrm(ks[19], (DEPTH, D_MODEL, 2 * D_FF), D_MODEL ** -0.5),
        "conv_w": nrm(ks[20], (DEPTH, CONV_W, 2 * D_FF), CONV_W ** -0.5),
        "conv_b": nrm(ks[21], (DEPTH, 2 * D_FF), 0.01),
        "w_down": nrm(ks[22], (DEPTH, D_FF, D_MODEL), D_FF ** -0.5 * DN_BETA),
        "ln3_g": 1.0 + nrm(ks[23], (DEPTH, D_MODEL), 0.01),
        "ln3_b": nrm(ks[24], (DEPTH, D_MODEL), 0.01),
    }


def reference(x_prompt, x_sample, cache_sb_k, cache_sb_v, state_ret, state_ffn_conv,
              cache_mem_k, cache_mem_v, mem_prompt,
              w_in, w_o, ln1_g, ln1_b, w_q_mem, w_k_mem, w_v_mem, w_o_mem, ln2_g, ln2_b,
              w_up, conv_w, conv_b, w_down, ln3_g, ln3_b):
    xp, xs = x_prompt, x_sample
    bp = xp.shape[0]
    past_len = cache_sb_k.shape[3]
    p_k, p_v, p_s, p_c, p_mk, p_mv = [], [], [], [], [], []
    s_k, s_v, s_s, s_c = [], [], [], []
    for l in range(DEPTH):
        lw = (w_in[l], w_o[l], ln1_g[l], ln1_b[l], w_q_mem[l], w_o_mem[l], ln2_g[l], ln2_b[l],
              w_up[l], conv_w[l], conv_b[l], w_down[l], ln3_g[l], ln3_b[l])
        mk = split_heads(mem_prompt @ w_k_mem[l], MEM_HEADS)
        mv = split_heads(mem_prompt @ w_v_mem[l], MEM_HEADS)
        zero_s = jnp.zeros((bp, RET_HEADS, RET_DK, RET_DV), xp.dtype)
        zero_kv = jnp.zeros((bp, SB_HEADS, 0, SB_DH), xp.dtype)
        zero_c = jnp.zeros((bp, CONV_W - 1, 2 * D_FF), xp.dtype)
        xp, pk, pv, ps, pc = trunk_layer(xp, mk, mv, zero_s, zero_kv, zero_kv, zero_c, 0, *lw)
        p_k.append(pk); p_v.append(pv); p_s.append(ps); p_c.append(pc); p_mk.append(mk); p_mv.append(mv)
        xs, sk, sv, ss, sc = trunk_layer(xs, cache_mem_k[l], cache_mem_v[l], state_ret[l],
                                         cache_sb_k[l], cache_sb_v[l], state_ffn_conv[l], past_len, *lw)
        s_k.append(sk); s_v.append(sv); s_s.append(ss); s_c.append(sc)
    new_sb_k_prompt = jnp.stack(p_k)
    new_sb_v_prompt = jnp.stack(p_v)
    new_state_ret_prompt = jnp.stack(p_s)
    new_ffn_conv_prompt = jnp.stack(p_c)
    new_mem_k_prompt = jnp.stack(p_mk)
    new_mem_v_prompt = jnp.stack(p_mv)
    new_sb_k_sample = jnp.stack(s_k)
    new_sb_v_sample = jnp.stack(s_v)
    new_state_ret_sample = jnp.stack(s_s)
    new_ffn_conv_sample = jnp.stack(s_c)
    return (xp, xs, new_sb_k_prompt, new_sb_v_prompt, new_state_ret_prompt, new_ffn_conv_prompt,
            new_mem_k_prompt, new_mem_v_prompt, new_sb_k_sample, new_sb_v_sample,
            new_state_ret_sample, new_ffn_conv_sample)
```

```cpp
#include <hip/hip_runtime.h>
#include <hip/hip_cooperative_groups.h>
#include <cstdio>
#include <cstdint>
#include <cmath>
namespace cg = cooperative_groups;
constexpr size_t O_XF = 0, O_SBK_P = 17301504, O_SBV_P = O_SBK_P + 8388608, O_RET_P = O_SBV_P + 8388608, O_CONV_P = O_RET_P + 262144, O_MK_P = O_CONV_P + 45056,
                 O_MV_P = O_MK_P + 1048576, O_SBK_S = O_MV_P + 1048576, O_SBV_S = O_SBK_S + 262144, O_RET_S = O_SBV_S + 262144, O_CONV_S = O_RET_S + 1048576, O_END = O_CONV_S + 180224;
namespace pg8 {
#define PG8_LAS __attribute__((address_space(3)))
typedef unsigned short bf16_t;
typedef short bf16x8 __attribute__((ext_vector_type(8)));
typedef float f32x4 __attribute__((ext_vector_type(4)));
typedef unsigned u32x4 __attribute__((ext_vector_type(4)));
constexpr int BM = 256, BK = 64, HALF = 128, HTB = HALF * BK * 2  , STAGE_BYTES = 8 * HTB, NXCD = 8, WGM = 8;

__host__ __device__ __forceinline__ int lds_byte(int r, int c) { const int st = (r >> 4) * 2 + (c >> 5), rr = r & 15, cc = c & 31, ob = rr * 64 + cc * 2; return st * 1024 + (ob ^ (((ob >> 9) & 1) << 5)); }
__host__ __device__ __forceinline__ void stage_rc(int b, int& R, int& C) { const int st = b / 1024, sb = b % 1024, swz = sb ^ (((sb >> 9) & 1) << 5); R = (st >> 1) * 16 + swz / 64; C = (st & 1) * 32 + (swz % 64) / 2; }
__host__ __device__ __forceinline__ int perm32(int rho) { const int n = rho >> 4, i = rho & 15; return 8 * (i >> 2) + 4 * n + (i & 3); }

struct Unit { int pm, pn; };
struct Gemm { const bf16_t* A; const bf16_t* Bt; int M, N, K; };

struct StaticOrder {
    int nM, nN, nwg, G, c;
    __host__ __device__ void init(int M, int N, int G_, int c_) { nM = M / BM; nN = N / BM; nwg = nM * nN; G = G_; c = c_; }
    __host__ __device__ bool next(int i, Unit& u) const {
        const long L = (long)i * G + c; if (L >= nwg) return false;
        int wgid = (int)L; { const int q = nwg / NXCD, r = nwg % NXCD, xcd = wgid % NXCD, off = wgid / NXCD; wgid = (xcd < r ? xcd * (q + 1) : r * (q + 1) + (xcd - r) * q) + off; }
        const int nig = WGM * nN, gid = wgid / nig, fm = gid * WGM, gsz = (nM - fm) < WGM ? (nM - fm) : WGM;
        u.pm = fm + ((wgid % nig) % gsz); u.pn = (wgid % nig) / gsz; return true;
    }
    __device__ __forceinline__ void a_ready(const Unit&) const {}
    __device__ __forceinline__ void done(const Unit&) const {}
};

__device__ __forceinline__ unsigned cvt_pk_bf16(float lo, float hi) { unsigned r; asm volatile("v_cvt_pk_bf16_f32 %0, %1, %2" : "=v"(r) : "v"(lo), "v"(hi)); return r; }
typedef unsigned u32x2 __attribute__((ext_vector_type(2)));
struct EpiG1 {
    static constexpr bool PERM = true, AFTER_DRAIN = false;
    bf16_t* PROJ; const float* rope; float* out;
    __device__ __forceinline__ void operator()(const f32x4 (&acc)[2][2][4][2], const Unit& u, int wr, int wc, int fr, int fq) const {
        const int pn = u.pn; const int cb = pn * BM + wc * 32 + 8 * fq;
#pragma unroll
        for (int ai = 0; ai < 2; ++ai)
#pragma unroll
            for (int m = 0; m < 4; ++m) {
                const int r = u.pm * BM + ai * HALF + wr * 64 + m * 16 + fr;
                int b, t, pos, TT; const bool samp = r >= 16384;
                if (!samp) { b = r >> 12; t = r & 4095; pos = t; TT = 4096; } else { const int rr = r - 16384; b = rr >> 5; t = rr & 31; pos = 2048 + t; TT = 32; }
                bf16_t* rowp = PROJ + (size_t)r * 3584 + cb;
                if (pn < 4) {
                    const float sc = pn >= 2 ? 0.08838834764831845f : 1.0f;
                    const f32x4* tp = (const f32x4*)(rope + ((size_t)pos * 64 + 16 * wc + 4 * fq) * 2);
                    const f32x4 t0 = tp[0], t1 = tp[1];
#pragma unroll
                    for (int bj = 0; bj < 2; ++bj) { const f32x4 v0 = acc[ai][bj][m][0], v1 = acc[ai][bj][m][1];
                        const float a0 = (v0[0] * t0[0] - v0[1] * t0[1]) * sc, a1 = (v0[0] * t0[1] + v0[1] * t0[0]) * sc;
                        const float a2 = (v0[2] * t0[2] - v0[3] * t0[3]) * sc, a3 = (v0[2] * t0[3] + v0[3] * t0[2]) * sc;
                        const float a4 = (v1[0] * t1[0] - v1[1] * t1[1]) * sc, a5 = (v1[0] * t1[1] + v1[1] * t1[0]) * sc;
                        const float a6 = (v1[2] * t1[2] - v1[3] * t1[3]) * sc, a7 = (v1[2] * t1[3] + v1[3] * t1[2]) * sc;
                        u32x4 w; w.x = cvt_pk_bf16(a0, a1); w.y = cvt_pk_bf16(a2, a3); w.z = cvt_pk_bf16(a4, a5); w.w = cvt_pk_bf16(a6, a7);
                        *(u32x4*)(rowp + bj * HALF) = w; }
                } else {
#pragma unroll
                    for (int bj = 0; bj < 2; ++bj) { const f32x4 v0 = acc[ai][bj][m][0], v1 = acc[ai][bj][m][1];
                        u32x4 w; w.x = cvt_pk_bf16(v0[0], v0[1]); w.y = cvt_pk_bf16(v0[2], v0[3]); w.z = cvt_pk_bf16(v1[0], v1[1]); w.w = cvt_pk_bf16(v1[2], v1[3]);
                        *(u32x4*)(rowp + bj * HALF) = w;
                        if (pn >= 10) { const int c = cb + bj * HALF - (pn >= 12 ? 3072 : 2560); const int hh = c >> 6, d = c & 63;
                            const size_t ob = samp ? (pn >= 12 ? O_SBV_S : O_SBK_S) : (pn >= 12 ? O_SBV_P : O_SBK_P);
                            float* op = out + ob + ((size_t)(b * 8 + hh) * TT + t) * 64 + d;
                            *(f32x4*)op = v0; *(f32x4*)(op + 4) = v1; } }
                }
            }
    }
};
struct EpiKV {
    static constexpr bool PERM = true, AFTER_DRAIN = false;
    bf16_t* MK; bf16_t* MVT; float* out;
    __device__ __forceinline__ void operator()(const f32x4 (&acc)[2][2][4][2], const Unit& u, int wr, int wc, int fr, int fq) const {
        const int pn = u.pn; const int hh = pn & 3; const bool isv = pn >= 4;
#pragma unroll
        for (int ai = 0; ai < 2; ++ai)
#pragma unroll
            for (int m = 0; m < 4; ++m) {
                const int r = u.pm * BM + ai * HALF + wr * 64 + m * 16 + fr; const int b = r >> 8, mm = r & 255;
#pragma unroll
                for (int bj = 0; bj < 2; ++bj) { const f32x4 v0 = acc[ai][bj][m][0], v1 = acc[ai][bj][m][1];
                    const int d = bj * HALF + wc * 32 + 8 * fq;
                    const size_t idx = ((size_t)(b * 4 + hh) * 256 + mm) * 256 + d;
                    float* op = out + (isv ? O_MV_P : O_MK_P) + idx; *(f32x4*)op = v0; *(f32x4*)(op + 4) = v1;
                    if (!isv) { u32x4 w; w.x = cvt_pk_bf16(v0[0], v0[1]); w.y = cvt_pk_bf16(v0[2], v0[3]); w.z = cvt_pk_bf16(v1[0], v1[1]); w.w = cvt_pk_bf16(v1[2], v1[3]);
                        *(u32x4*)(MK + idx) = w; }
                    else { bf16_t* tb = MVT + ((size_t)(b * 4 + hh) * 256 + d) * 256 + mm;
                        const unsigned w0 = cvt_pk_bf16(v0[0], v0[1]), w1 = cvt_pk_bf16(v0[2], v0[3]), w2 = cvt_pk_bf16(v1[0], v1[1]), w3 = cvt_pk_bf16(v1[2], v1[3]);
                        tb[0] = (bf16_t)w0; tb[256] = (bf16_t)(w0 >> 16); tb[512] = (bf16_t)w1; tb[768] = (bf16_t)(w1 >> 16);
                        tb[1024] = (bf16_t)w2; tb[1280] = (bf16_t)(w2 >> 16); tb[1536] = (bf16_t)w3; tb[1792] = (bf16_t)(w3 >> 16); } }
            }
    }
};
struct EpiRes {
    static constexpr bool PERM = false, AFTER_DRAIN = false;
    float* XF; const float* xp; const float* xs; float alpha;
    __device__ __forceinline__ void operator()(const f32x4 (&acc)[2][2][4][2], const Unit& u, int wr, int wc, int fr, int fq) const {
        const int col0 = u.pn * BM + wc * 32 + 4 * fq;
#pragma unroll
        for (int ai = 0; ai < 2; ++ai)
#pragma unroll
            for (int m = 0; m < 4; ++m) {
                const int r = u.pm * BM + ai * HALF + wr * 64 + m * 16 + fr;
                float* rowp = XF + (size_t)r * 1024 + col0;
                const float* sp = xp ? (r < 16384 ? xp + (size_t)r * 1024 : xs + (size_t)(r - 16384) * 1024) + col0 : rowp;
#pragma unroll
                for (int bj = 0; bj < 2; ++bj)
#pragma unroll
                    for (int n = 0; n < 2; ++n) { const f32x4 s = *(const f32x4*)(sp + bj * HALF + n * 16); *(f32x4*)(rowp + bj * HALF + n * 16) = s * alpha + acc[ai][bj][m][n]; }
            }
    }
};
template <bool CONV> struct EpiPlain {
    static constexpr bool PERM = true, AFTER_DRAIN = false;
    bf16_t* O; int ldc; float scale; float* out;
    __device__ __forceinline__ void operator()(const f32x4 (&acc)[2][2][4][2], const Unit& u, int wr, int wc, int fr, int fq) const {
        const int cb = u.pn * BM + wc * 32 + 8 * fq;
#pragma unroll
        for (int ai = 0; ai < 2; ++ai)
#pragma unroll
            for (int m = 0; m < 4; ++m) {
                const int r = u.pm * BM + ai * HALF + wr * 64 + m * 16 + fr;
                bf16_t* rowp = O + (size_t)r * ldc + cb;
#pragma unroll
                for (int bj = 0; bj < 2; ++bj) { const f32x4 v0 = acc[ai][bj][m][0] * scale, v1 = acc[ai][bj][m][1] * scale;
                    u32x4 w; w.x = cvt_pk_bf16(v0[0], v0[1]); w.y = cvt_pk_bf16(v0[2], v0[3]); w.z = cvt_pk_bf16(v1[0], v1[1]); w.w = cvt_pk_bf16(v1[2], v1[3]);
                    *(u32x4*)(rowp + bj * HALF) = w;
                    if (CONV) {
                        bool st = false; size_t off = 0;
                        if (r < 16384) { const int t = r & 4095; if (t >= 4094) { st = true; off = O_CONV_P + ((size_t)(r >> 12) * 2 + (t - 4094)) * 5632; } }
                        else { const int rr = r - 16384; const int t = rr & 31; if (t >= 30) { st = true; off = O_CONV_S + ((size_t)(rr >> 5) * 2 + (t - 30)) * 5632; } }
                        if (st) { float* op = out + off + cb + bj * HALF; *(f32x4*)op = v0; *(f32x4*)(op + 4) = v1; } } }
            }
    }
};
template <class Epi, class Sched, bool ALIGN_EPI = false, bool SP2 = false>
__device__ __forceinline__ void gemm_phase(PG8_LAS unsigned char* lds, const Gemm g, const Sched& S, const Epi& E) {
    const int tid = threadIdx.x, wid = __builtin_amdgcn_readfirstlane(tid >> 6), lane = tid & 63, wr = wid >> 2, wc = wid & 3, fr = lane & 15, fq = lane >> 4;
    const int K = g.K, nt = K / BK;
    unsigned voffA[2], voffB[2];
#pragma unroll
    for (int i = 0; i < 2; ++i) { int R, C; stage_rc(tid * 16 + i * 8192, R, C); const int Rb = Epi::PERM ? ((R & ~31) + perm32(R & 31)) : R;
        voffA[i] = (unsigned)(R * K + C) * 2u; voffB[i] = (unsigned)(Rb * K + C) * 2u; }
    const size_t kstep = (size_t)(BK * 2);
    const size_t hstep = (size_t)HALF * K * 2;
    const size_t tstep = 2 * hstep;
    const unsigned ldsw = (unsigned)wid * 1024u;
    const int aoff = lds_byte(wr * 64 + fr, fq * 8), boff = lds_byte(wc * 32 + fr, fq * 8);
#define PG8_SA(b, h) (((b) * 2 + (h)) * HTB)
#define PG8_SB(b, h) ((4 + (b) * 2 + (h)) * HTB)
#define PG8_STAGE(bufoff, gbase, voff) do { _Pragma("unroll") for (int _i = 0; _i < 2; ++_i) \
        __builtin_amdgcn_global_load_lds((const unsigned*)((const char*)(gbase) + (voff)[_i]), (PG8_LAS unsigned*)(lds + (bufoff) + ldsw + _i * 8192), 16, 0, 0); } while (0)
#define PG8_LDA(dst, b, h) do { _Pragma("unroll") for (int m = 0; m < 4; ++m) _Pragma("unroll") for (int k = 0; k < 2; ++k) dst[m][k] = *(const PG8_LAS bf16x8*)(lds + PG8_SA(b, h) + aoff + m * 2048 + k * 1024); } while (0)
#define PG8_LDB(dst, b, h) do { _Pragma("unroll") for (int n = 0; n < 2; ++n) _Pragma("unroll") for (int k = 0; k < 2; ++k) dst[n][k] = *(const PG8_LAS bf16x8*)(lds + PG8_SB(b, h) + boff + n * 2048 + k * 1024); } while (0)
#define PG8_MMA(ai, bj, At, Bt) do { __builtin_amdgcn_s_setprio(1); _Pragma("unroll") for (int m = 0; m < 4; ++m) _Pragma("unroll") for (int n = 0; n < 2; ++n) _Pragma("unroll") for (int k = 0; k < 2; ++k) \
        acc[ai][bj][m][n] = __builtin_amdgcn_mfma_f32_16x16x32_bf16(Bt[n][k], At[m][k], acc[ai][bj][m][n], 0, 0, 0); __builtin_amdgcn_s_setprio(0); } while (0)
#define PG8_WAIT_V(n) asm volatile("s_waitcnt vmcnt(" #n ")" ::: "memory")
#define PG8_WAIT_L(n) asm volatile("s_waitcnt lgkmcnt(" #n ")" ::: "memory")
#define PG8_BAR __builtin_amdgcn_s_barrier()
#define PG8_SCHED __builtin_amdgcn_sched_barrier(0)
    Unit cur, nxt; int ui = 0;
    if (!S.next(0, cur)) return;
    f32x4 acc[2][2][4][2];
#pragma unroll
    for (int a = 0; a < 2; ++a)
#pragma unroll
        for (int b = 0; b < 2; ++b)
#pragma unroll
            for (int m = 0; m < 4; ++m)
#pragma unroll
                for (int n = 0; n < 2; ++n) acc[a][b][m][n] = (f32x4){0.f, 0.f, 0.f, 0.f};
    bf16x8 At[4][2], B0[2][2], B1[2][2];
    const char* cA = (const char*)g.A + (size_t)cur.pm * tstep; const char* cB = (const char*)g.Bt + (size_t)cur.pn * tstep;
    S.a_ready(cur);
    if constexpr (SP2) {
        PG8_STAGE(PG8_SB(0, 0), cB, voffB); PG8_STAGE(PG8_SB(0, 1), cB + hstep, voffB); PG8_STAGE(PG8_SA(0, 0), cA, voffA); PG8_STAGE(PG8_SA(0, 1), cA + hstep, voffA);
        if (wr == 1) PG8_BAR;
        PG8_WAIT_V(2); PG8_BAR;
        PG8_STAGE(PG8_SB(1, 0), cB + kstep, voffB); PG8_STAGE(PG8_SA(1, 0), cA + kstep, voffA); PG8_STAGE(PG8_SB(1, 1), cB + hstep + kstep, voffB);
        PG8_WAIT_V(6); PG8_BAR;
    } else {
        PG8_STAGE(PG8_SB(0, 0), cB, voffB); PG8_STAGE(PG8_SA(0, 0), cA, voffA); PG8_STAGE(PG8_SB(0, 1), cB + hstep, voffB); PG8_STAGE(PG8_SA(0, 1), cA + hstep, voffA);
        if (wr == 1) PG8_BAR;
        PG8_WAIT_V(4); PG8_BAR;
        PG8_STAGE(PG8_SB(1, 0), cB + kstep, voffB); PG8_STAGE(PG8_SA(1, 0), cA + kstep, voffA); PG8_STAGE(PG8_SB(1, 1), cB + hstep + kstep, voffB);
        PG8_WAIT_V(6); PG8_BAR;
    }
    for (;;) {
        const bool has_next = S.next(ui + 1, nxt);
        const char* nA = has_next ? (const char*)g.A + (size_t)nxt.pm * tstep : cA; const char* nB = has_next ? (const char*)g.Bt + (size_t)nxt.pn * tstep : cB;
        for (int t = 0; t < nt; t += 2) {
            const bool last = (t == nt - 2);
            const char* a1 = cA + (size_t)(t + 1) * kstep;
            const char* a2 = last ? nA : cA + (size_t)(t + 2) * kstep; const char* b2 = last ? nB : cB + (size_t)(t + 2) * kstep;
            const char* a3 = a2 + kstep; const char* b3 = b2 + kstep;
            if (last && has_next) S.a_ready(nxt);
            if constexpr (SP2) {
            PG8_LDB(B0, 0, 0); PG8_LDB(B1, 0, 1); PG8_SCHED; PG8_LDA(At, 0, 0); PG8_STAGE(PG8_SA(1, 1), a1 + hstep, voffA);
            PG8_WAIT_V(8); PG8_WAIT_L(0); PG8_BAR; PG8_MMA(0, 0, At, B0); PG8_MMA(0, 1, At, B1); PG8_BAR; PG8_SCHED;
            PG8_LDA(At, 0, 1); PG8_STAGE(PG8_SB(0, 0), b2, voffB); PG8_STAGE(PG8_SB(0, 1), b2 + hstep, voffB); PG8_STAGE(PG8_SA(0, 0), a2, voffA);
            PG8_WAIT_V(8); PG8_WAIT_L(0); PG8_BAR; PG8_MMA(1, 0, At, B0); PG8_MMA(1, 1, At, B1); PG8_BAR; PG8_SCHED;
            PG8_LDB(B0, 1, 0); PG8_LDB(B1, 1, 1); PG8_SCHED; PG8_LDA(At, 1, 0); PG8_STAGE(PG8_SA(0, 1), a2 + hstep, voffA);
            PG8_WAIT_V(8); PG8_WAIT_L(0); PG8_BAR; PG8_MMA(0, 0, At, B0); PG8_MMA(0, 1, At, B1); PG8_BAR; PG8_SCHED;
            PG8_LDA(At, 1, 1); PG8_STAGE(PG8_SB(1, 0), b3, voffB); PG8_STAGE(PG8_SB(1, 1), b3 + hstep, voffB); PG8_STAGE(PG8_SA(1, 0), a3, voffA);
            PG8_WAIT_V(8); PG8_WAIT_L(0); PG8_BAR; PG8_MMA(1, 0, At, B0); PG8_MMA(1, 1, At, B1); PG8_BAR; PG8_SCHED;
            } else {
            PG8_LDB(B0, 0, 0); PG8_SCHED; PG8_LDA(At, 0, 0); PG8_STAGE(PG8_SA(1, 1), a1 + hstep, voffA);
            PG8_WAIT_L(8); PG8_BAR; PG8_WAIT_L(0); PG8_MMA(0, 0, At, B0); PG8_BAR; PG8_SCHED;
            PG8_LDB(B1, 0, 1); PG8_STAGE(PG8_SB(0, 0), b2, voffB);
            PG8_BAR; PG8_WAIT_L(0); PG8_MMA(0, 1, At, B1); PG8_BAR;
            PG8_LDA(At, 0, 1); PG8_STAGE(PG8_SA(0, 0), a2, voffA);
            PG8_BAR; PG8_WAIT_L(0); PG8_MMA(1, 0, At, B0); PG8_BAR; PG8_SCHED;
            PG8_STAGE(PG8_SB(0, 1), b2 + hstep, voffB);
            PG8_WAIT_V(6); PG8_BAR; PG8_MMA(1, 1, At, B1); PG8_BAR;
            PG8_LDB(B0, 1, 0); PG8_SCHED; PG8_LDA(At, 1, 0); PG8_STAGE(PG8_SA(0, 1), a2 + hstep, voffA);
            PG8_WAIT_L(8); PG8_BAR; PG8_WAIT_L(0); PG8_MMA(0, 0, At, B0); PG8_BAR; PG8_SCHED;
            PG8_LDB(B1, 1, 1); PG8_STAGE(PG8_SB(1, 0), b3, voffB);
            PG8_BAR; PG8_WAIT_L(0); PG8_MMA(0, 1, At, B1); PG8_BAR;
            PG8_LDA(At, 1, 1); PG8_STAGE(PG8_SA(1, 0), a3, voffA);
            PG8_BAR; PG8_WAIT_L(0); PG8_MMA(1, 0, At, B0); PG8_BAR; PG8_SCHED;
            PG8_STAGE(PG8_SB(1, 1), b3 + hstep, voffB);
            PG8_WAIT_V(6); PG8_BAR; PG8_MMA(1, 1, At, B1); PG8_BAR;
            }
        }
        if constexpr (ALIGN_EPI) { if (wr == 0) PG8_BAR; }
        if constexpr (!Epi::AFTER_DRAIN) { E(acc, cur, wr, wc, fr, fq); S.done(cur); }
        if (!has_next) break;
#pragma unroll
        for (int a = 0; a < 2; ++a)
#pragma unroll
            for (int b = 0; b < 2; ++b)
#pragma unroll
                for (int m = 0; m < 4; ++m)
#pragma unroll
                    for (int n = 0; n < 2; ++n) acc[a][b][m][n] = (f32x4){0.f, 0.f, 0.f, 0.f};
        cur = nxt; cA = nA; cB = nB; ++ui;
        if constexpr (ALIGN_EPI) { if (wr == 1) PG8_BAR; }
    }
    PG8_WAIT_V(0);
    if constexpr (!ALIGN_EPI) { if (wr == 0) PG8_BAR; }
    PG8_BAR;
    if constexpr (Epi::AFTER_DRAIN) { E.fused(acc, cur, wr, wc, fr, fq, lds, wid, lane); S.done(cur); }
#undef PG8_SA
#undef PG8_SB
#undef PG8_STAGE
#undef PG8_LDA
#undef PG8_LDB
#undef PG8_MMA
#undef PG8_WAIT_V
#undef PG8_WAIT_L
#undef PG8_BAR
#undef PG8_SCHED
}
}
#ifndef PG8_SP2
#define PG8_SP2 true
#endif
#ifndef PG8_ALIGN
#define PG8_ALIGN true
#endif
#define LAS __attribute__((address_space(3)))
typedef unsigned short bf16;
typedef short bf16x8 __attribute__((ext_vector_type(8)));
typedef float f32x4 __attribute__((ext_vector_type(4)));
typedef float f32x16 __attribute__((ext_vector_type(16)));
typedef unsigned v4u __attribute__((ext_vector_type(4)));
typedef unsigned v2u __attribute__((ext_vector_type(2)));
constexpr int NWAVES = 8;
constexpr int MT = 16896, MP = 16384;
constexpr int LDS_BYTES = 147456, RING_BYTES = 131072;
constexpr float LOG2E = 1.4426950408889634f, LN2 = 0.6931471805599453f;
constexpr float DN_ALPHA = 1.189207115002721f;
constexpr size_t MiB = 1u << 20;
constexpr size_t WS_WDOWN = 1 * MiB, WS_WUP = 7 * MiB, WS_WIN = 18 * MiB, WS_WO = 25 * MiB, WS_WQ = 27 * MiB, WS_WKV = 29 * MiB, WS_WOM = 33 * MiB;
constexpr size_t WS_MEMB = 35 * MiB, WS_MK = 37 * MiB, WS_MVT = 47 * MiB, WS_XB = 57 * MiB  , WS_PROJ = 90 * MiB, WS_UT = 206 * MiB;
constexpr size_t WS_ROPE = 274 * MiB;
constexpr size_t WS_QM = 90 * MiB, WS_OM = 123 * MiB, WS_UU = 112 * MiB, WS_H = 7 * MiB;
constexpr size_t WS_NEED = WS_UU + (size_t)MT * 5632 * 2;

struct Ctx {
    const float *x_p, *x_s, *cache_k, *cache_v, *state_ret, *state_conv, *cmem_k, *cmem_v, *mem_p;
    const float *w_in, *w_o, *ln1_g, *ln1_b, *w_q, *w_k, *w_v, *w_om, *ln2_g, *ln2_b, *w_up, *conv_w, *conv_b, *w_down, *ln3_g, *ln3_b;
    float* out; unsigned char* ws;
};
__device__ __forceinline__ unsigned cvtpk(float lo, float hi) { return pg8::cvt_pk_bf16(lo, hi); }
__device__ __forceinline__ bf16x8 pack8(f32x4 a, f32x4 b) { v4u w; w.x = cvtpk(a[0], a[1]); w.y = cvtpk(a[2], a[3]); w.z = cvtpk(b[0], b[1]); w.w = cvtpk(b[2], b[3]); return __builtin_bit_cast(bf16x8, w); }
__device__ __forceinline__ float bf2f(unsigned short v) { return __uint_as_float((unsigned)v << 16); }
__device__ __forceinline__ float fexp2(float x) { return __builtin_amdgcn_exp2f(x); }
__device__ __forceinline__ float flog2(float x) { return __builtin_amdgcn_logf(x); }
#define LDS_WAIT() asm volatile("s_waitcnt lgkmcnt(0)" ::: "memory")
#define MFMA32(a, b, c) __builtin_amdgcn_mfma_f32_32x32x16_bf16((a), (b), (c), 0, 0, 0)
__device__ __forceinline__ int crow(int i, int h) { return (i & 3) + 8 * (i >> 2) + 4 * h; }
__device__ __forceinline__ float loggam(int h) { return log1pf(-exp2f(-5.0f - (float)h)); }
__device__ __forceinline__ int dperm(int p) { return (p >> 1) + 64 * (p & 1); }

template <bool ROPEPERM> __device__ __forceinline__ void p0_transpose_item(const float* W, int K, int N, bf16* WT, int row_off, LAS float* scr, int item, int lane) {
    const int nblk = N / 32, kb = item / nblk, nb = item % nblk, k0 = 64 * kb, n0 = 32 * nb;
#pragma unroll 8
    for (int i = 0; i < 32; ++i) { const int kk = 2 * i + (lane >> 5); scr[kk * 33 + (lane & 31)] = W[(size_t)(k0 + kk) * N + n0 + (lane & 31)]; }
    LDS_WAIT();
    const int c = lane & 7;
#pragma unroll
    for (int j = 0; j < 4; ++j) { const int n = (lane >> 3) + 8 * j; const LAS float* s = scr + (8 * c) * 33 + n;
        v4u o; o.x = cvtpk(s[0 * 33], s[1 * 33]); o.y = cvtpk(s[2 * 33], s[3 * 33]); o.z = cvtpk(s[4 * 33], s[5 * 33]); o.w = cvtpk(s[6 * 33], s[7 * 33]);
        int dr = n0 + n;
        if (ROPEPERM) { if (dr < 1024) { const int hd = dr >> 7, d = dr & 127; dr = (hd << 7) + 2 * (d & 63) + (d >> 6); } }
        *(v4u*)(WT + (size_t)(row_off + dr) * K + k0 + 8 * c) = o; }
    LDS_WAIT();
}
__device__ __forceinline__ void cvt_row(const float* src, bf16* dst, int lane) {
    const f32x4* s = (const f32x4*)src + lane; v2u* d = (v2u*)dst + lane;
#pragma unroll
    for (int j = 0; j < 4; ++j) { const f32x4 v = s[64 * j]; v2u o; o.x = cvtpk(v[0], v[1]); o.y = cvtpk(v[2], v[3]); d[64 * j] = o; }
}
__device__ __forceinline__ void phase_prep(const Ctx& c, LAS unsigned char* lds, int wave, int lane) {
    LAS float* scr = (LAS float*)(lds + wave * 16384);
    const int gw = blockIdx.x * NWAVES + wave, NGW = gridDim.x * NWAVES;
    unsigned char* ws = c.ws;
    constexpr int I_IN = 16 * 112, I_SQ = 16 * 32, I_UP = 16 * 176, I_DN = 44 * 32, I_MV = 64 * 32;
    constexpr int NIT = I_IN + 5 * I_SQ + I_UP + I_DN + I_MV;
    for (int it = gw; it < NIT; it += NGW) {
        int r = it;
        if (r < I_IN) { p0_transpose_item<true>(c.w_in, 1024, 3584, (bf16*)(ws + WS_WIN), 0, scr, r, lane); continue; } r -= I_IN;
        if (r < I_SQ) { p0_transpose_item<false>(c.w_o, 1024, 1024, (bf16*)(ws + WS_WO), 0, scr, r, lane); continue; } r -= I_SQ;
        if (r < I_SQ) { p0_transpose_item<false>(c.w_q, 1024, 1024, (bf16*)(ws + WS_WQ), 0, scr, r, lane); continue; } r -= I_SQ;
        if (r < I_SQ) { p0_transpose_item<false>(c.w_k, 1024, 1024, (bf16*)(ws + WS_WKV), 0, scr, r, lane); continue; } r -= I_SQ;
        if (r < I_SQ) { p0_transpose_item<false>(c.w_v, 1024, 1024, (bf16*)(ws + WS_WKV), 1024, scr, r, lane); continue; } r -= I_SQ;
        if (r < I_SQ) { p0_transpose_item<false>(c.w_om, 1024, 1024, (bf16*)(ws + WS_WOM), 0, scr, r, lane); continue; } r -= I_SQ;
        if (r < I_UP) { p0_transpose_item<false>(c.w_up, 1024, 5632, (bf16*)(ws + WS_WUP), 0, scr, r, lane); continue; } r -= I_UP;
        if (r < I_DN) { p0_transpose_item<false>(c.w_down, 2816, 1024, (bf16*)(ws + WS_WDOWN), 0, scr, r, lane); continue; } r -= I_DN;
        { const int mat = r >> 5, sub = r & 31;
          p0_transpose_item<false>(c.cmem_v + (size_t)mat * 65536, 256, 256, (bf16*)(ws + WS_MVT) + (size_t)(16 + mat) * 65536, 0, scr, sub, lane); }
    }
    for (int m = gw; m < MT + 1024 + 4096; m += NGW) {
        if (m < MT) cvt_row(m < MP ? c.x_p + (size_t)m * 1024 : c.x_s + (size_t)(m - MP) * 1024, (bf16*)(ws + WS_XB) + (size_t)m * 1024, lane);
        else if (m < MT + 1024) cvt_row(c.mem_p + (size_t)(m - MT) * 1024, (bf16*)(ws + WS_MEMB) + (size_t)(m - MT) * 1024, lane);
        else cvt_row(c.cmem_k + (size_t)(m - MT - 1024) * 1024, (bf16*)(ws + WS_MK) + (size_t)16 * 65536 + (size_t)(m - MT - 1024) * 1024, lane);
    }
    float* rope = (float*)(ws + WS_ROPE);
    for (int e = (blockIdx.x * NWAVES + wave) * 64 + lane; e < 4096 * 64; e += NGW * 64) {
        const int pos = e >> 6, i = e & 63;
        const float inv = 1.0f / powf(10000.0f, (float)i * (1.0f / 64.0f));
        const float ang = (float)pos * inv;
        double rev = (double)ang * 0.15915494309189535; rev -= floor(rev);
        const float fr = (float)rev;
        rope[2 * e] = __builtin_amdgcn_cosf(fr); rope[2 * e + 1] = __builtin_amdgcn_sinf(fr);
    }
}

__device__ __forceinline__ void sb_item(const Ctx& c, int item, LAS unsigned char* wl, int lane) {
    const bf16* PROJ = (const bf16*)(c.ws + WS_PROJ); bf16* MIX = (bf16*)(c.ws + WS_XB);
    int b, head, qb, past, rowbase; const float* ck = nullptr; const float* cv = nullptr;
    if (item < 4096) { b = item >> 10; head = (item >> 7) & 7; qb = item & 127; past = 0; rowbase = b * 4096; }
    else { const int it = item - 4096; b = it >> 3; head = it & 7; qb = 0; past = 2048; rowbase = MP + b * 32;
           ck = c.cache_k + (size_t)(b * 8 + head) * 2048 * 64; cv = c.cache_v + (size_t)(b * 8 + head) * 2048 * 64; }
    const int r = lane & 31, h = lane >> 5;
    constexpr int VP = 72;
    LAS unsigned short* Vs = (LAS unsigned short*)wl;
    const bf16* qrow = PROJ + (size_t)(rowbase + qb * 32 + r) * 3584 + 2048 + head * 64 + 8 * h;
    bf16x8 qf[4];
#pragma unroll
    for (int s = 0; s < 4; ++s) qf[s] = *(const bf16x8*)(qrow + 16 * s);
    f32x16 o0, o1;
#pragma unroll
    for (int i = 0; i < 16; ++i) { o0[i] = 0.f; o1[i] = 0.f; }
    float carry = 0.f;
    const int kt_hi = (past + qb * 32) >> 5;
    for (int kt = kt_hi; kt >= 0; --kt) {
        const int kpos0 = kt * 32;
        bf16x8 kf[4]; v4u vv[4];
        if (kpos0 >= past) {
            const bf16* krow = PROJ + (size_t)(rowbase + kpos0 - past + r) * 3584 + 2560 + head * 64 + 8 * h;
#pragma unroll
            for (int s = 0; s < 4; ++s) kf[s] = *(const bf16x8*)(krow + 16 * s);
            const bf16* vrow = PROJ + (size_t)(rowbase + kpos0 - past + (lane >> 1)) * 3584 + 3072 + head * 64 + (lane & 1) * 32;
#pragma unroll
            for (int i = 0; i < 4; ++i) vv[i] = *(const v4u*)(vrow + 8 * i);
        } else {
            const float* krow = ck + (size_t)(kpos0 + r) * 64 + 8 * h;
#pragma unroll
            for (int s = 0; s < 4; ++s) kf[s] = pack8(*(const f32x4*)(krow + 16 * s), *(const f32x4*)(krow + 16 * s + 4));
            const float* vrow = cv + (size_t)(kpos0 + (lane >> 1)) * 64 + (lane & 1) * 32;
#pragma unroll
            for (int i = 0; i < 4; ++i) vv[i] = __builtin_bit_cast(v4u, pack8(*(const f32x4*)(vrow + 8 * i), *(const f32x4*)(vrow + 8 * i + 4)));
        }
        LDS_WAIT();
#pragma unroll
        for (int i = 0; i < 4; ++i) *(LAS v4u*)(Vs + (lane >> 1) * VP + (lane & 1) * 32 + 8 * i) = vv[i];
        f32x16 st;
#pragma unroll
        for (int i = 0; i < 16; ++i) st[i] = 0.f;
#pragma unroll
        for (int s = 0; s < 4; ++s) st = MFMA32(kf[s], qf[s], st);
        const bool diag = (kt == kt_hi);
        float lf[16], ls[16];
#pragma unroll
        for (int i = 0; i < 16; ++i) {
            const float z = st[i] * 0.125f;
            const float tt = flog2(1.0f + fexp2(-fabsf(z) * LOG2E)) * LN2;
            const bool valid = !diag || (crow(i, h) < r);
            lf[i] = valid ? (fminf(-z, 0.f) - tt) : 0.f;
            ls[i] = fminf(z, 0.f) - tt;
            if (!valid) ls[i] = -__builtin_inff();
        }
        float gs[4], ps[4], offs[4];
#pragma unroll
        for (int g = 0; g < 4; ++g) { gs[g] = (lf[4 * g] + lf[4 * g + 1]) + (lf[4 * g + 2] + lf[4 * g + 3]); ps[g] = __shfl_xor(gs[g], 32); }
        float run = 0.f;
#pragma unroll
        for (int g = 3; g >= 0; --g) { offs[g] = run + (h == 0 ? ps[g] : 0.f); run += gs[g] + ps[g]; }
        float a[16];
#pragma unroll
        for (int g = 0; g < 4; ++g) {
            const float base = carry + offs[g];
            const float a3 = base, a2 = a3 + lf[4 * g + 3], a1 = a2 + lf[4 * g + 2], a0 = a1 + lf[4 * g + 1];
            a[4 * g + 0] = fexp2((ls[4 * g + 0] + a0) * LOG2E); a[4 * g + 1] = fexp2((ls[4 * g + 1] + a1) * LOG2E);
            a[4 * g + 2] = fexp2((ls[4 * g + 2] + a2) * LOG2E); a[4 * g + 3] = fexp2((ls[4 * g + 3] + a3) * LOG2E);
        }
        carry += run;
        bf16x8 xf[2];
#pragma unroll
        for (int s = 0; s < 2; ++s) xf[s] = pack8((f32x4){a[8 * s], a[8 * s + 1], a[8 * s + 2], a[8 * s + 3]}, (f32x4){a[8 * s + 4], a[8 * s + 5], a[8 * s + 6], a[8 * s + 7]});
        LDS_WAIT();
#pragma unroll
        for (int s = 0; s < 2; ++s) {
            bf16x8 vf0, vf1;
#pragma unroll
            for (int j = 0; j < 8; ++j) { const int key = 16 * s + 8 * (j >> 2) + 4 * h + (j & 3); vf0[j] = (short)Vs[key * VP + r]; vf1[j] = (short)Vs[key * VP + 32 + r]; }
            o0 = MFMA32(vf0, xf[s], o0); o1 = MFMA32(vf1, xf[s], o1);
        }
        if (kt > 0 && __all(carry < -104.0f)) break;
    }
    LDS_WAIT();
    bf16* orow = MIX + (size_t)(rowbase + qb * 32 + r) * 1024 + 512 + head * 64 + 4 * h;
#pragma unroll
    for (int g = 0; g < 4; ++g) {
        v2u w0; w0.x = cvtpk(o0[4 * g], o0[4 * g + 1]); w0.y = cvtpk(o0[4 * g + 2], o0[4 * g + 3]); *(v2u*)(orow + 8 * g) = w0;
        v2u w1; w1.x = cvtpk(o1[4 * g], o1[4 * g + 1]); w1.y = cvtpk(o1[4 * g + 2], o1[4 * g + 3]); *(v2u*)(orow + 32 + 8 * g) = w1;
    }
}

__device__ __forceinline__ void retu_item(const Ctx& c, int item, LAS unsigned char* wl, int lane) {
    const bf16* PROJ = (const bf16*)(c.ws + WS_PROJ); float* UT = (float*)(c.ws + WS_UT);
    int bh, n, es, C, rowbase; bool samp = false;
    if (item < 4096) { bh = item >> 8; n = (item >> 2) & 63; es = item & 3; C = 64; rowbase = (bh >> 2) * 4096 + n * 64; }
    else { const int it = item - 4096; bh = it >> 2; es = it & 3; n = 0; C = 32; rowbase = MP + (bh >> 2) * 32; samp = true; }
    const int hh = bh & 3, r = lane & 31, h = lane >> 5;
    const float lg2 = loggam(hh) * LOG2E;
    constexpr int VP2 = 40, KP = 72;
    LAS unsigned short* Vs = (LAS unsigned short*)wl; LAS unsigned short* Ks = Vs + 64 * VP2;
    LDS_WAIT();
    for (int idx = lane; idx < C * 4; idx += 64) { const int j = idx >> 2, part = idx & 3;
        const v4u raw = *(const v4u*)(PROJ + (size_t)(rowbase + j) * 3584 + 1024 + hh * 128 + es * 32 + part * 8);
        const float kd = fexp2(lg2 * (float)(C - 1 - j));
        v4u o;
#pragma unroll
        for (int q = 0; q < 4; ++q) { const unsigned w = raw[q]; o[q] = cvtpk(__uint_as_float(w << 16) * kd, __uint_as_float(w & 0xffff0000u) * kd); }
        *(LAS v4u*)(Vs + j * VP2 + part * 8) = o; }
    const int nks = C >> 4;
    for (int ph = 0; ph < 2; ++ph) {
        LDS_WAIT();
        for (int idx = lane; idx < C * 8; idx += 64) { const int j = idx >> 3, part = idx & 7;
            *(LAS v4u*)(Ks + j * KP + part * 8) = *(const v4u*)(PROJ + (size_t)(rowbase + j) * 3584 + 512 + hh * 128 + ph * 64 + part * 8); }
        LDS_WAIT();
        f32x16 a0, a1;
#pragma unroll
        for (int i = 0; i < 16; ++i) { a0[i] = 0.f; a1[i] = 0.f; }
        for (int s = 0; s < nks; ++s) {
            bf16x8 bf, af0, af1;
#pragma unroll
            for (int j = 0; j < 8; ++j) { const int jj = 16 * s + 8 * h + j; bf[j] = (short)Vs[jj * VP2 + r]; af0[j] = (short)Ks[jj * KP + r]; af1[j] = (short)Ks[jj * KP + 32 + r]; }
            a0 = MFMA32(af0, bf, a0); a1 = MFMA32(af1, bf, a1);
        }
        const int e = es * 32 + r;
#pragma unroll
        for (int pt = 0; pt < 2; ++pt)
#pragma unroll
            for (int g = 0; g < 4; ++g) {
                const int p0 = ph * 64 + pt * 32 + 8 * g + 4 * h;
                f32x4 v; if (pt == 0) v = (f32x4){a0[4 * g], a0[4 * g + 1], a0[4 * g + 2], a0[4 * g + 3]}; else v = (f32x4){a1[4 * g], a1[4 * g + 1], a1[4 * g + 2], a1[4 * g + 3]};
                if (!samp) *(f32x4*)(UT + ((size_t)(bh * 64 + n) * 128 + e) * 128 + p0) = v;
                else { const float g32 = fexp2(lg2 * 32.0f);
#pragma unroll
                    for (int q = 0; q < 4; ++q) { const size_t idx = ((size_t)bh * 128 + dperm(p0 + q)) * 128 + e; c.out[O_RET_S + idx] = g32 * c.state_ret[idx] + v[q]; } }
            }
    }
    LDS_WAIT();
}

__device__ __forceinline__ void phase_scan(const Ctx& c) {
    float* UT = (float*)(c.ws + WS_UT);
    const int nth = gridDim.x * 512;
    for (int idx = blockIdx.x * 512 + threadIdx.x; idx < 16 * 16384; idx += nth) {
        const int bh = idx >> 14, ep = idx & 16383;
        float* u = UT + (size_t)bh * 64 * 16384 + ep;
        const float g64 = fexp2(loggam(bh & 3) * LOG2E * 64.0f);
        float s = 0.f;
        for (int n0 = 0; n0 < 64; n0 += 8) {
            float t[8];
#pragma unroll
            for (int k = 0; k < 8; ++k) t[k] = u[(size_t)(n0 + k) * 16384];
#pragma unroll
            for (int k = 0; k < 8; ++k) { u[(size_t)(n0 + k) * 16384] = s; s = g64 * s + t[k]; }
        }
        const int e = ep >> 7, p = ep & 127;
        c.out[O_RET_P + ((size_t)bh * 128 + dperm(p)) * 128 + e] = s;
    }
}

__device__ __forceinline__ void reto_item(const Ctx& c, int item, LAS unsigned char* wl, int lane) {
    const bf16* PROJ = (const bf16*)(c.ws + WS_PROJ); const float* UT = (const float*)(c.ws + WS_UT); bf16* MIX = (bf16*)(c.ws + WS_XB);
    int bh, n, ih, rowbase; bool samp = false;
    if (item < 2048) { bh = item >> 7; n = (item >> 1) & 63; ih = item & 1; rowbase = (bh >> 2) * 4096 + n * 64; }
    else { bh = item - 2048; n = 0; ih = 0; rowbase = MP + (bh >> 2) * 32; samp = true; }
    const int hh = bh & 3, r = lane & 31, h = lane >> 5;
    const float lg2 = loggam(hh) * LOG2E;
    const int iloc = 32 * ih + r, token = rowbase + iloc;
    LAS unsigned short* Vs = (LAS unsigned short*)wl;
    LDS_WAIT();
    { const int nj = 32 * (ih + 1);
      for (int idx = lane; idx < nj * 16; idx += 64) { const int j = idx >> 4, part = idx & 15;
          *(LAS v4u*)(Vs + j * 128 + part * 8) = *(const v4u*)(PROJ + (size_t)(rowbase + j) * 3584 + 1024 + hh * 128 + part * 8); } }
    bf16x8 qf[8];
    { const bf16* qrow = PROJ + (size_t)token * 3584 + hh * 128 + 8 * h;
#pragma unroll
      for (int s = 0; s < 8; ++s) qf[s] = *(const bf16x8*)(qrow + 16 * s); }
    f32x16 acc[4];
#pragma unroll
    for (int et = 0; et < 4; ++et)
#pragma unroll
        for (int i = 0; i < 16; ++i) acc[et][i] = 0.f;
#pragma unroll
    for (int et = 0; et < 4; ++et) {
        const int e = 32 * et + r;
#pragma unroll
        for (int s = 0; s < 8; ++s) {
            const int p0 = 16 * s + 8 * h;
            bf16x8 af;
            if (!samp) { const float* sp = UT + ((size_t)(bh * 64 + n) * 128 + e) * 128 + p0; af = pack8(*(const f32x4*)sp, *(const f32x4*)(sp + 4)); }
            else { const float* sb = c.state_ret + (size_t)bh * 16384 + e; float t[8];
#pragma unroll
                for (int q = 0; q < 8; ++q) t[q] = sb[(size_t)dperm(p0 + q) * 128];
                af = pack8((f32x4){t[0], t[1], t[2], t[3]}, (f32x4){t[4], t[5], t[6], t[7]}); }
            acc[et] = MFMA32(af, qf[s], acc[et]);
        }
    }
    { const float qd = fexp2(lg2 * (float)(iloc + 1));
#pragma unroll
      for (int et = 0; et < 4; ++et)
#pragma unroll
          for (int i = 0; i < 16; ++i) acc[et][i] *= qd; }
    LDS_WAIT();
    for (int jt = 0; jt <= ih; ++jt) {
        f32x16 X;
#pragma unroll
        for (int i = 0; i < 16; ++i) X[i] = 0.f;
        const bf16* krow = PROJ + (size_t)(rowbase + 32 * jt + r) * 3584 + 512 + hh * 128 + 8 * h;
#pragma unroll
        for (int s = 0; s < 8; ++s) { const bf16x8 kf = *(const bf16x8*)(krow + 16 * s); X = MFMA32(kf, qf[s], X); }
#pragma unroll
        for (int i = 0; i < 16; ++i) { const int diff = iloc - (32 * jt + crow(i, h)); X[i] = diff >= 0 ? X[i] * fexp2(lg2 * (float)diff) : 0.f; }
#pragma unroll
        for (int s2 = 0; s2 < 2; ++s2) {
            const bf16x8 xf = pack8((f32x4){X[8 * s2], X[8 * s2 + 1], X[8 * s2 + 2], X[8 * s2 + 3]}, (f32x4){X[8 * s2 + 4], X[8 * s2 + 5], X[8 * s2 + 6], X[8 * s2 + 7]});
#pragma unroll
            for (int et = 0; et < 4; ++et) {
                bf16x8 vf;
#pragma unroll
                for (int j = 0; j < 8; ++j) vf[j] = (short)Vs[(32 * jt + 16 * s2 + 8 * (j >> 2) + 4 * h + (j & 3)) * 128 + 32 * et + r];
                acc[et] = MFMA32(vf, xf, acc[et]);
            }
        }
    }
    float ss = 0.f;
#pragma unroll
    for (int et = 0; et < 4; ++et)
#pragma unroll
        for (int i = 0; i < 16; ++i) ss += acc[et][i] * acc[et][i];
    ss += __shfl_xor(ss, 32);
    const float rinv = 1.0f / sqrtf(ss * (1.0f / 128.0f) + 1e-6f);
    const bf16* grow = PROJ + (size_t)token * 3584 + 1536 + hh * 128 + 4 * h;
    bf16* orow = MIX + (size_t)token * 1024 + hh * 128 + 4 * h;
#pragma unroll
    for (int et = 0; et < 4; ++et)
#pragma unroll
        for (int g = 0; g < 4; ++g) {
            const v2u gw = *(const v2u*)(grow + 32 * et + 8 * g);
            float gv[4] = {__uint_as_float(gw.x << 16), __uint_as_float(gw.x & 0xffff0000u), __uint_as_float(gw.y << 16), __uint_as_float(gw.y & 0xffff0000u)};
            float ov[4];
#pragma unroll
            for (int q = 0; q < 4; ++q) { const float x = gv[q]; const float sg = x / (1.0f + fexp2(-x * LOG2E)); ov[q] = acc[et][4 * g + q] * rinv * sg; }
            v2u w; w.x = cvtpk(ov[0], ov[1]); w.y = cvtpk(ov[2], ov[3]); *(v2u*)(orow + 32 * et + 8 * g) = w;
        }
    LDS_WAIT();
}

__device__ __forceinline__ float wave_sum(float v) {
#pragma unroll
    for (int o = 1; o < 64; o <<= 1) v += __shfl_xor(v, o);
    return v;
}
__device__ __forceinline__ void ln_row(float* xrow, const float* g, const float* bt, bf16* orow, int lane) {
    f32x4* xr = (f32x4*)xrow + lane; f32x4 v[4]; float s = 0.f;
#pragma unroll
    for (int j = 0; j < 4; ++j) { v[j] = xr[64 * j]; s += (v[j][0] + v[j][1]) + (v[j][2] + v[j][3]); }
    const float mean = wave_sum(s) * (1.0f / 1024.0f); float s2 = 0.f;
#pragma unroll
    for (int j = 0; j < 4; ++j) { v[j] = v[j] - mean; s2 += (v[j][0] * v[j][0] + v[j][1] * v[j][1]) + (v[j][2] * v[j][2] + v[j][3] * v[j][3]); }
    const float rstd = 1.0f / sqrtf(wave_sum(s2) * (1.0f / 1024.0f) + 1e-5f);
#pragma unroll
    for (int j = 0; j < 4; ++j) { const f32x4 gg = ((const f32x4*)g)[64 * j + lane], bb = ((const f32x4*)bt)[64 * j + lane];
        const f32x4 y = v[j] * rstd * gg + bb; xr[64 * j] = y;
        if (orow) { v2u o; o.x = cvtpk(y[0], y[1]); o.y = cvtpk(y[2], y[3]); ((v2u*)orow)[64 * j + lane] = o; } }
}
__device__ __forceinline__ void phase_ln(const Ctx& c, const float* g, const float* bt, bf16* ob, int wave, int lane) {
    const int gw = blockIdx.x * NWAVES + wave, NGW = gridDim.x * NWAVES;
    for (int m = gw; m < MT; m += NGW) ln_row(c.out + O_XF + (size_t)m * 1024, g, bt, ob ? ob + (size_t)m * 1024 : nullptr, lane);
}

__device__ __forceinline__ void mem_item(const Ctx& c, int item, int lane) {
    const bf16* QM = (const bf16*)(c.ws + WS_QM); bf16* OM = (bf16*)(c.ws + WS_OM);
    const int hd = item / 528, rb = item % 528, row0 = rb * 32;
    const int gb = row0 < MP ? (row0 >> 12) : 4 + ((row0 - MP) >> 5);
    const bf16* Kb = (const bf16*)(c.ws + WS_MK) + (size_t)(gb * 4 + hd) * 65536;
    const bf16* Vb = (const bf16*)(c.ws + WS_MVT) + (size_t)(gb * 4 + hd) * 65536;
    const int r = lane & 31, h = lane >> 5;
    f32x16 st[8];
#pragma unroll
    for (int mt = 0; mt < 8; ++mt)
#pragma unroll
        for (int i = 0; i < 16; ++i) st[mt][i] = 0.f;
#pragma unroll
    for (int half = 0; half < 2; ++half) {
        bf16x8 qf[8];
        const bf16* qrow = QM + (size_t)(row0 + r) * 1024 + hd * 256 + half * 128 + 8 * h;
#pragma unroll
        for (int s = 0; s < 8; ++s) qf[s] = *(const bf16x8*)(qrow + 16 * s);
#pragma unroll
        for (int mt = 0; mt < 8; ++mt) {
            const bf16* krow = Kb + (size_t)(32 * mt + r) * 256 + half * 128 + 8 * h;
#pragma unroll
            for (int s = 0; s < 8; ++s) { const bf16x8 kf = *(const bf16x8*)(krow + 16 * s); st[mt] = MFMA32(kf, qf[s], st[mt]); }
        }
    }
    float mx = -__builtin_inff();
#pragma unroll
    for (int mt = 0; mt < 8; ++mt)
#pragma unroll
        for (int i = 0; i < 16; ++i) mx = fmaxf(mx, st[mt][i]);
    mx = fmaxf(mx, __shfl_xor(mx, 32));
    float sum = 0.f;
#pragma unroll
    for (int mt = 0; mt < 8; ++mt)
#pragma unroll
        for (int i = 0; i < 16; ++i) { const float p = fexp2((st[mt][i] - mx) * LOG2E); st[mt][i] = p; sum += p; }
    sum += __shfl_xor(sum, 32);
    const float inv = 1.0f / sum;
    bf16x8 pf[8][2];
#pragma unroll
    for (int mt = 0; mt < 8; ++mt)
#pragma unroll
        for (int s = 0; s < 2; ++s)
            pf[mt][s] = pack8((f32x4){st[mt][8 * s] * inv, st[mt][8 * s + 1] * inv, st[mt][8 * s + 2] * inv, st[mt][8 * s + 3] * inv},
                              (f32x4){st[mt][8 * s + 4] * inv, st[mt][8 * s + 5] * inv, st[mt][8 * s + 6] * inv, st[mt][8 * s + 7] * inv});
#pragma unroll
    for (int dh = 0; dh < 2; ++dh) {
        f32x16 acc[4];
#pragma unroll
        for (int dt = 0; dt < 4; ++dt)
#pragma unroll
            for (int i = 0; i < 16; ++i) acc[dt][i] = 0.f;
#pragma unroll
        for (int mt = 0; mt < 8; ++mt)
#pragma unroll
            for (int s = 0; s < 2; ++s)
#pragma unroll
                for (int dt = 0; dt < 4; ++dt) {
                    const bf16* vp = Vb + (size_t)(dh * 128 + 32 * dt + r) * 256 + 32 * mt + 16 * s + 4 * h;
                    const v2u lo = *(const v2u*)vp, hi = *(const v2u*)(vp + 8);
                    v4u w; w.x = lo.x; w.y = lo.y; w.z = hi.x; w.w = hi.y;
                    acc[dt] = MFMA32(__builtin_bit_cast(bf16x8, w), pf[mt][s], acc[dt]);
                }
        bf16* orow = OM + (size_t)(row0 + r) * 1024 + hd * 256 + dh * 128 + 4 * h;
#pragma unroll
        for (int dt = 0; dt < 4; ++dt)
#pragma unroll
            for (int g = 0; g < 4; ++g) { v2u w; w.x = cvtpk(acc[dt][4 * g], acc[dt][4 * g + 1]); w.y = cvtpk(acc[dt][4 * g + 2], acc[dt][4 * g + 3]); *(v2u*)(orow + 32 * dt + 8 * g) = w; }
    }
}

__device__ __forceinline__ void phase_conv(const Ctx& c) {
    const bf16* UU = (const bf16*)(c.ws + WS_UU); bf16* H = (bf16*)(c.ws + WS_H);
    const int nth = gridDim.x * 512;
    for (int idx = blockIdx.x * 512 + threadIdx.x; idx < (MT / 8) * 352; idx += nth) {
        const int rbk = idx / 352, cc = idx % 352, j0 = cc * 8, row0 = rbk * 8;
        float w[3][2][8], bb[2][8];
#pragma unroll
        for (int k = 0; k < 3; ++k)
#pragma unroll
            for (int p = 0; p < 2; ++p) { const float* wp = c.conv_w + (size_t)k * 5632 + p * 2816 + j0; const f32x4 x0 = *(const f32x4*)wp, x1 = *(const f32x4*)(wp + 4);
#pragma unroll
                for (int q = 0; q < 4; ++q) { w[k][p][q] = x0[q]; w[k][p][4 + q] = x1[q]; } }
#pragma unroll
        for (int p = 0; p < 2; ++p) { const float* bp = c.conv_b + p * 2816 + j0; const f32x4 x0 = *(const f32x4*)bp, x1 = *(const f32x4*)(bp + 4);
#pragma unroll
            for (int q = 0; q < 4; ++q) { bb[p][q] = x0[q]; bb[p][4 + q] = x1[q]; } }
        float um2[2][8], um1[2][8];
        int t0; const float* past = nullptr;
        if (row0 < MP) t0 = row0 & 4095; else { const int rr = row0 - MP; t0 = rr & 31; past = c.state_conv + (size_t)(rr >> 5) * 2 * 5632; }
#pragma unroll
        for (int p = 0; p < 2; ++p) {
            if (t0 == 0) {
                if (past) { const float* p0 = past + p * 2816 + j0; const float* p1 = p0 + 5632;
#pragma unroll
                    for (int q = 0; q < 8; ++q) { um2[p][q] = p0[q]; um1[p][q] = p1[q]; } }
                else {
#pragma unroll
                    for (int q = 0; q < 8; ++q) { um2[p][q] = 0.f; um1[p][q] = 0.f; } }
            } else {
                const v4u a = *(const v4u*)(UU + (size_t)(row0 - 2) * 5632 + p * 2816 + j0), b = *(const v4u*)(UU + (size_t)(row0 - 1) * 5632 + p * 2816 + j0);
#pragma unroll
                for (int q = 0; q < 4; ++q) { um2[p][2 * q] = __uint_as_float(a[q] << 16); um2[p][2 * q + 1] = __uint_as_float(a[q] & 0xffff0000u);
                                              um1[p][2 * q] = __uint_as_float(b[q] << 16); um1[p][2 * q + 1] = __uint_as_float(b[q] & 0xffff0000u); }
            }
        }
#pragma unroll
        for (int rr = 0; rr < 8; ++rr) {
            float u0[2][8];
#pragma unroll
            for (int p = 0; p < 2; ++p) { const v4u a = *(const v4u*)(UU + (size_t)(row0 + rr) * 5632 + p * 2816 + j0);
#pragma unroll
                for (int q = 0; q < 4; ++q) { u0[p][2 * q] = __uint_as_float(a[q] << 16); u0[p][2 * q + 1] = __uint_as_float(a[q] & 0xffff0000u); } }
            float hv[8];
#pragma unroll
            for (int q = 0; q < 8; ++q) {
                const float ca = bb[0][q] + w[0][0][q] * um2[0][q] + w[1][0][q] * um1[0][q] + w[2][0][q] * u0[0][q];
                const float cg = bb[1][q] + w[0][1][q] * um2[1][q] + w[1][1][q] * um1[1][q] + w[2][1][q] * u0[1][q];
                hv[q] = ca / (1.0f + fexp2(-ca * LOG2E)) * cg;
            }
            v4u o; o.x = cvtpk(hv[0], hv[1]); o.y = cvtpk(hv[2], hv[3]); o.z = cvtpk(hv[4], hv[5]); o.w = cvtpk(hv[6], hv[7]);
            *(v4u*)(H + (size_t)(row0 + rr) * 2816 + j0) = o;
#pragma unroll
            for (int p = 0; p < 2; ++p)
#pragma unroll
                for (int q = 0; q < 8; ++q) { um2[p][q] = um1[p][q]; um1[p][q] = u0[p][q]; }
        }
    }
}

constexpr int NPHASE = 15;
struct Args { Ctx c; int ph_lo, ph_hi; };
__global__ void __launch_bounds__(NWAVES * 64, 2) fwd_kernel(Args args) {
    extern __shared__ __attribute__((aligned(16))) unsigned char lds_raw[];
    LAS unsigned char* lds = (LAS unsigned char*)lds_raw;
    const Ctx& c = args.c;
    const int tid = threadIdx.x, lane = tid & 63, wave = __builtin_amdgcn_readfirstlane(tid >> 6);
    const int gw = blockIdx.x * NWAVES + wave, NGW = gridDim.x * NWAVES;
    LAS unsigned char* wl = lds + wave * 16384;
    const int lo = args.ph_lo, hi = args.ph_hi;
    cg::grid_group grid = cg::this_grid();
    unsigned char* ws = c.ws;
#define IN(k) (lo <= (k) && (k) < hi)
#define SEAM(k) do { if (IN(k) && IN((k) + 1)) grid.sync(); } while (0)
    typedef pg8::bf16_t pbf;
    if (IN(0)) { phase_prep(c, lds, wave, lane); } SEAM(0);
    if (IN(1)) {
        { pg8::Gemm g{(const pbf*)(ws + WS_XB), (const pbf*)(ws + WS_WIN), MT, 3584, 1024}; pg8::StaticOrder S; S.init(MT, 3584, gridDim.x, blockIdx.x);
          pg8::EpiG1 E{(pbf*)(ws + WS_PROJ), (const float*)(ws + WS_ROPE), c.out};
          pg8::gemm_phase<pg8::EpiG1, pg8::StaticOrder, PG8_ALIGN, PG8_SP2>(lds, g, S, E); }
        { pg8::Gemm g{(const pbf*)(ws + WS_MEMB), (const pbf*)(ws + WS_WKV), 1024, 2048, 1024}; pg8::StaticOrder S; S.init(1024, 2048, gridDim.x, (blockIdx.x + 96) % gridDim.x);
          pg8::EpiKV E{(pbf*)(ws + WS_MK), (pbf*)(ws + WS_MVT), c.out};
          pg8::gemm_phase<pg8::EpiKV, pg8::StaticOrder, PG8_ALIGN, PG8_SP2>(lds, g, S, E); }
    } SEAM(1);
    if (IN(2)) {
        for (int it = gw; it < 4096 + 256; it += NGW) retu_item(c, it, wl, lane);
        for (int it = gw; it < 4096 + 128; it += NGW) sb_item(c, it, wl, lane);
    } SEAM(2);
    if (IN(3)) { phase_scan(c); } SEAM(3);
    if (IN(4)) { for (int it = gw; it < 2048 + 64; it += NGW) reto_item(c, it, wl, lane); } SEAM(4);
    if (IN(5)) {
        pg8::Gemm g{(const pbf*)(ws + WS_XB), (const pbf*)(ws + WS_WO), MT, 1024, 1024}; pg8::StaticOrder S; S.init(MT, 1024, gridDim.x, blockIdx.x);
        pg8::EpiRes E{c.out + O_XF, c.x_p, c.x_s, DN_ALPHA};
        pg8::gemm_phase<pg8::EpiRes, pg8::StaticOrder, PG8_ALIGN, PG8_SP2>(lds, g, S, E);
    } SEAM(5);
    if (IN(6)) { phase_ln(c, c.ln1_g, c.ln1_b, (bf16*)(ws + WS_XB), wave, lane); } SEAM(6);
    if (IN(7)) {
        pg8::Gemm g{(const pbf*)(ws + WS_XB), (const pbf*)(ws + WS_WQ), MT, 1024, 1024}; pg8::StaticOrder S; S.init(MT, 1024, gridDim.x, blockIdx.x);
        pg8::EpiPlain<false> E{(pbf*)(ws + WS_QM), 1024, 0.0625f, nullptr};
        pg8::gemm_phase<pg8::EpiPlain<false>, pg8::StaticOrder, PG8_ALIGN, PG8_SP2>(lds, g, S, E);
    } SEAM(7);
    if (IN(8)) { for (int it = gw; it < 4 * 528; it += NGW) mem_item(c, it, lane); } SEAM(8);
    if (IN(9)) {
        pg8::Gemm g{(const pbf*)(ws + WS_OM), (const pbf*)(ws + WS_WOM), MT, 1024, 1024}; pg8::StaticOrder S; S.init(MT, 1024, gridDim.x, blockIdx.x);
        pg8::EpiRes E{c.out + O_XF, nullptr, nullptr, DN_ALPHA};
        pg8::gemm_phase<pg8::EpiRes, pg8::StaticOrder, PG8_ALIGN, PG8_SP2>(lds, g, S, E);
    } SEAM(9);
    if (IN(10)) { phase_ln(c, c.ln2_g, c.ln2_b, (bf16*)(ws + WS_XB), wave, lane); } SEAM(10);
    if (IN(11)) {
        pg8::Gemm g{(const pbf*)(ws + WS_XB), (const pbf*)(ws + WS_WUP), MT, 5632, 1024}; pg8::StaticOrder S; S.init(MT, 5632, gridDim.x, blockIdx.x);
        pg8::EpiPlain<true> E{(pbf*)(ws + WS_UU), 5632, 1.0f, c.out};
        pg8::gemm_phase<pg8::EpiPlain<true>, pg8::StaticOrder, PG8_ALIGN, PG8_SP2>(lds, g, S, E);
    } SEAM(11);
    if (IN(12)) { phase_conv(c); } SEAM(12);
    if (IN(13)) {
        pg8::Gemm g{(const pbf*)(ws + WS_H), (const pbf*)(ws + WS_WDOWN), MT, 1024, 2816}; pg8::StaticOrder S; S.init(MT, 1024, gridDim.x, blockIdx.x);
        pg8::EpiRes E{c.out + O_XF, nullptr, nullptr, DN_ALPHA};
        pg8::gemm_phase<pg8::EpiRes, pg8::StaticOrder, PG8_ALIGN, PG8_SP2>(lds, g, S, E);
    } SEAM(13);
    if (IN(14)) { phase_ln(c, c.ln3_g, c.ln3_b, nullptr, wave, lane); }
#undef IN
#undef SEAM
}

#ifndef ONE_LAUNCH
#define ONE_LAUNCH 0
#endif
extern "C" void kernel_launch(void* const* d_in, const int* in_sizes, int n_in, void* d_out, int out_size, void* d_ws, size_t ws_size, hipStream_t stream) {
    static int grid = 0;
    if (grid == 0) {
        if (n_in != 25 || ws_size < WS_NEED) { fprintf(stderr, "kernel_launch: unexpected shapes: n_in %d out %d ws %zu (need %zu)\n", n_in, out_size, ws_size, (size_t)WS_NEED); grid = -1; return; }
        int dev = 0, cus = 0;
        hipGetDevice(&dev); hipDeviceGetAttribute(&cus, hipDeviceAttributeMultiprocessorCount, dev);
        if (hipFuncSetAttribute((const void*)fwd_kernel, hipFuncAttributeMaxDynamicSharedMemorySize, LDS_BYTES) != hipSuccess) { fprintf(stderr, "kernel_launch: hipFuncSetAttribute failed\n"); grid = -1; return; }
        int per_cu = 0;
        if (hipOccupancyMaxActiveBlocksPerMultiprocessor(&per_cu, (const void*)fwd_kernel, NWAVES * 64, LDS_BYTES) != hipSuccess || per_cu < 1) { fprintf(stderr, "kernel_launch: occupancy query says %d\n", per_cu); }
        (void)hipGetLastError();
        grid = cus > 0 ? cus : 256;
    }
    if (grid < 0) return;
    Args a{};
    const float** ip = (const float**)&a.c;
    for (int i = 0; i < 25; ++i) ip[i] = (const float*)d_in[i];
    a.c.out = (float*)d_out; a.c.ws = (unsigned char*)d_ws;
#if ONE_LAUNCH
    a.ph_lo = 0; a.ph_hi = NPHASE;
    void* kargs[] = {&a};
    hipError_t e = hipLaunchCooperativeKernel((const void*)fwd_kernel, dim3(grid), dim3(NWAVES * 64), kargs, LDS_BYTES, stream);
    if (e != hipSuccess) fprintf(stderr, "cooperative launch failed: %s (grid %d)\n", hipGetErrorString(e), grid);
#else
    for (int p = 0; p < NPHASE; ++p) { a.ph_lo = p; a.ph_hi = p + 1; hipLaunchKernelGGL(fwd_kernel, dim3(grid), dim3(NWAVES * 64), LDS_BYTES, stream, a); }
#endif
}
```
